# Optimizing an MI355X kernel written in HIP

```python
import math
import jax, jax.numpy as jnp
from jax import lax
import numpy as np

D_MODEL = 1024
BATCH = 4
SEQ = 4096
DEPTH = 1

CHUNK = 64
N_HEADS = 16
N_KV_HEADS = 4
HEAD_DIM = 64
WINDOW = 128
WINDOW_CHUNKS = WINDOW // CHUNK
N_BUCKETS = 32
MAX_DISTANCE = 128
LRU_WIDTH = D_MODEL
LRU_BLOCKS = 16
LRU_BLOCK = LRU_WIDTH // LRU_BLOCKS
CONV_WIDTH = 4
LRU_C = 8.0
D_FF = 2816
RMS_EPS = 1e-6
Q_W = N_HEADS * HEAD_DIM
KV_W = N_KV_HEADS * HEAD_DIM
IN_W = Q_W + 2 * KV_W + 2 * LRU_WIDTH
N_BRANCHES = 2
NEG_INF = -1e30

kernel_name = "hybrid_rglru_swa_sink_macaron"


def rms_norm(x, g):
    xf = x.astype(jnp.float32)
    y = xf * lax.rsqrt(jnp.mean(xf * xf, axis=-1, keepdims=True) + RMS_EPS)
    return (y * g.astype(jnp.float32)).astype(x.dtype)


def swiglu(x, w1, w3, w2):
    return (jax.nn.silu(x @ w1) * (x @ w3)) @ w2


def t5_bucket(rel):
    nb = N_BUCKETS // 2
    max_exact = nb // 2
    ret = jnp.where(rel > 0, nb, 0)
    n = jnp.abs(rel)
    nf = jnp.maximum(n, 1).astype(jnp.float32)
    large = max_exact + (jnp.log(nf / max_exact) / math.log(MAX_DISTANCE / max_exact)
                         * (nb - max_exact)).astype(jnp.int32)
    large = jnp.minimum(large, nb - 1)
    return ret + jnp.where(n < max_exact, n, large)


def band_rel_bias(table):
    kb = (WINDOW_CHUNKS + 1) * CHUNK
    i = jnp.arange(CHUNK)[:, None]
    j = jnp.arange(kb)[None, :]
    buckets = t5_bucket(j - WINDOW_CHUNKS * CHUNK - i)
    return jnp.transpose(table[buckets], (2, 0, 1))


def causal_conv(x, w, b):
    s = x.shape[1]
    xp = jnp.pad(x, ((0, 0), (CONV_WIDTH - 1, 0), (0, 0)))
    y = b
    for tap in range(CONV_WIDTH):
        y = y + xp[:, tap:tap + s] * w[tap]
    return y


def rg_lru(x, wa, ba, wx, bx, lam):
    b, s, _ = x.shape
    xf = x.astype(jnp.float32)
    xb = xf.reshape(b, s, LRU_BLOCKS, LRU_BLOCK)
    r = jax.nn.sigmoid(jnp.einsum('bshi,hij->bshj', xb, wa.astype(jnp.float32)).reshape(b, s, LRU_WIDTH) + ba)
    ig = jax.nn.sigmoid(jnp.einsum('bshi,hij->bshj', xb, wx.astype(jnp.float32)).reshape(b, s, LRU_WIDTH) + bx)
    log_a = -LRU_C * r * jax.nn.softplus(-lam.astype(jnp.float32))
    a = jnp.exp(log_a)
    u = jnp.sqrt(-jnp.expm1(2.0 * log_a)) * (ig * xf)

    def combine(c1, c2):
        a1, b1 = c1
        a2, b2 = c2
        return a1 * a2, a2 * b1 + b2

    _, h = lax.associative_scan(combine, (a, u), axis=1)
    return h.astype(x.dtype)


def swa_sink_attention(q, k, v, sinks, bias):
    b, s, _ = q.shape
    nc = s // CHUNK
    kb = (WINDOW_CHUNKS + 1) * CHUNK
    rep = N_HEADS // N_KV_HEADS
    qc = q.reshape(b, nc, CHUNK, N_KV_HEADS, rep, HEAD_DIM)
    pad = ((0, 0), (WINDOW_CHUNKS * CHUNK, 0), (0, 0))
    kp = jnp.pad(k, pad).reshape(b, nc + WINDOW_CHUNKS, CHUNK, N_KV_HEADS, HEAD_DIM)
    vp = jnp.pad(v, pad).reshape(b, nc + WINDOW_CHUNKS, CHUNK, N_KV_HEADS, HEAD_DIM)
    kband = jnp.concatenate([kp[:, w:w + nc] for w in range(WINDOW_CHUNKS + 1)], axis=2)
    vband = jnp.concatenate([vp[:, w:w + nc] for w in range(WINDOW_CHUNKS + 1)], axis=2)
    sc = jnp.einsum('bnqgrd,bnkgd->bngrqk', qc, kband).astype(jnp.float32) * (HEAD_DIM ** -0.5)
    sc = sc + bias.astype(jnp.float32).reshape(N_KV_HEADS, rep, CHUNK, kb)
    key_chunk = jnp.arange(nc)[:, None] - WINDOW_CHUNKS + jnp.arange(kb)[None, :] // CHUNK
    valid = key_chunk >= 0
    sc = jnp.where(valid[None, :, None, None, None, :], sc, NEG_INF)
    sink = jnp.broadcast_to(sinks.astype(jnp.float32).reshape(1, 1, N_KV_HEADS, rep, 1, 1),
                            sc.shape[:-1] + (1,))
    p = jax.nn.softmax(jnp.concatenate([sc, sink], axis=-1), axis=-1)[..., :-1]
    o = jnp.einsum('bngrqk,bnkgd->bnqgrd', p.astype(vband.dtype), vband)
    return o.reshape(b, s, Q_W)


def setup_inputs(seed: int = 0) -> dict:
    key = jax.random.key(seed)
    ks = jax.random.split(key, 32)
    f32 = jnp.float32
    L, D = DEPTH, D_MODEL

    def nrm(k, shape, scale):
        return jax.random.normal(k, shape, f32) * scale

    def gain(k):
        return 1.0 + 0.05 * jax.random.normal(k, (L, D), f32)

    a0 = jax.random.uniform(ks[10], (L, LRU_WIDTH), f32, 0.9, 0.999)
    return {
        "x": jax.random.normal(ks[0], (BATCH, SEQ, D), f32),
        "ffn1_pre_g": gain(ks[1]),
        "ffn1_w1": nrm(ks[2], (L, D, D_FF), D ** -0.5),
        "ffn1_w3": nrm(ks[3], (L, D, D_FF), D ** -0.5),
        "ffn1_w2": nrm(ks[4], (L, D_FF, D), D_FF ** -0.5),
        "ffn1_post_g": gain(ks[5]),
        "mix_pre_g": gain(ks[6]),
        "w_in": nrm(ks[7], (L, D, IN_W), D ** -0.5),
        "conv_w": nrm(ks[8], (L, CONV_WIDTH, LRU_WIDTH), CONV_WIDTH ** -0.5),
        "conv_b": nrm(ks[9], (L, LRU_WIDTH), 0.02),
        "rg_a_w": nrm(ks[11], (L, LRU_BLOCKS, LRU_BLOCK, LRU_BLOCK), LRU_BLOCK ** -0.5),
        "rg_a_b": nrm(ks[12], (L, LRU_WIDTH), 0.1),
        "rg_x_w": nrm(ks[13], (L, LRU_BLOCKS, LRU_BLOCK, LRU_BLOCK), LRU_BLOCK ** -0.5),
        "rg_x_b": nrm(ks[14], (L, LRU_WIDTH), 0.1),
        "lru_lambda": jnp.log(a0) - jnp.log1p(-a0),
        "w_lru_out": nrm(ks[15], (L, LRU_WIDTH, D), LRU_WIDTH ** -0.5),
        "attn_sinks": nrm(ks[16], (L, N_HEADS), 0.5),
        "rel_bias": nrm(ks[17], (N_BUCKETS, N_HEADS), 0.5),
        "w_attn_out": nrm(ks[18], (L, Q_W, D), Q_W ** -0.5),
        "w_gate": nrm(ks[19], (L, D, N_BRANCHES * D), D ** -0.5),
        "b_gate": nrm(ks[20], (L, N_BRANCHES * D), 0.1),
        "w_o": nrm(ks[21], (L, D, D), D ** -0.5),
        "mix_post_g": gain(ks[22]),
        "ffn2_pre_g": gain(ks[23]),
        "ffn2_w1": nrm(ks[24], (L, D, D_FF), D ** -0.5),
        "ffn2_w3": nrm(ks[25], (L, D, D_FF), D ** -0.5),
        "ffn2_w2": nrm(ks[26], (L, D_FF, D), D_FF ** -0.5),
        "ffn2_post_g": gain(ks[27]),
    }


def reference(x, ffn1_pre_g, ffn1_w1, ffn1_w3, ffn1_w2, ffn1_post_g, mix_pre_g, w_in, conv_w, conv_b,
              rg_a_w, rg_a_b, rg_x_w, rg_x_b, lru_lambda, w_lru_out, attn_sinks, rel_bias, w_attn_out,
              w_gate, b_gate, w_o, mix_post_g, ffn2_pre_g, ffn2_w1, ffn2_w3, ffn2_w2, ffn2_post_g):
    b, s, d = x.shape
    bias = band_rel_bias(rel_bias)
    splits = [Q_W, Q_W + KV_W, Q_W + 2 * KV_W, Q_W + 2 * KV_W + LRU_WIDTH]
    h = x
    for l in range(DEPTH):
        f = swiglu(rms_norm(h, ffn1_pre_g[l]), ffn1_w1[l], ffn1_w3[l], ffn1_w2[l])
        h = h + 0.5 * rms_norm(f, ffn1_post_g[l])
        u = rms_norm(h, mix_pre_g[l])
        q, k, v, xr, xg = jnp.split(u @ w_in[l], splits, axis=-1)
        xr = causal_conv(xr, conv_w[l], conv_b[l])
        hr = rg_lru(xr, rg_a_w[l], rg_a_b[l], rg_x_w[l], rg_x_b[l], lru_lambda[l])
        y_a = (hr * jax.nn.gelu(xg)) @ w_lru_out[l]
        y_b = swa_sink_attention(q, k, v, attn_sinks[l], bias) @ w_attn_out[l]
        g = jax.nn.sigmoid(u @ w_gate[l] + b_gate[l]).reshape(b, s, N_BRANCHES, d)
        merged = g[:, :, 0] * y_a + g[:, :, 1] * y_b
        h = h + rms_norm(merged @ w_o[l], mix_post_g[l])
        f = swiglu(rms_norm(h, ffn2_pre_g[l]), ffn2_w1[l], ffn2_w3[l], ffn2_w2[l])
        h = h + 0.5 * rms_norm(f, ffn2_post_g[l])
    return h
```

```cpp
#include <hip/hip_runtime.h>
#include <cstdint>
#include <cstdio>

typedef unsigned short bf16_t;
typedef short bf16x8 __attribute__((ext_vector_type(8)));
typedef float f32x4 __attribute__((ext_vector_type(4)));

constexpr int D = 1024, BATCH = 4, SEQ = 4096, M = BATCH * SEQ, DFF = 2816, INW = 3584;
constexpr int NH = 16, NKV = 4, HD = 64, CHUNK = 64;
constexpr float RMS_EPS = 1e-6f;

__device__ __forceinline__ unsigned f2bf(float f) { unsigned u = __builtin_bit_cast(unsigned, f); return (u + 0x7fffu + ((u >> 16) & 1u)) >> 16; }
__device__ __forceinline__ float bf2f(bf16_t h) { return __builtin_bit_cast(float, (unsigned)h << 16); }
__device__ __forceinline__ float wave_sum(float v) {
#pragma unroll
    for (int o = 1; o < 64; o <<= 1) v += __shfl_xor(v, o);
    return v;
}
__device__ __forceinline__ float sigmoidf_(float z) { return 1.0f / (1.0f + __expf(-z)); }
__device__ __forceinline__ float gelu_tanh(float x) {
    const float u = 0.7978845608028654f * (x + 0.044715f * x * x * x);
    const float t = 1.0f - 2.0f / (1.0f + __expf(2.0f * u));
    return 0.5f * x * (1.0f + t);
}

__global__ void __launch_bounds__(256) k_rmsnorm(const float* __restrict__ x, const float* __restrict__ g, bf16_t* __restrict__ out) {
    const int row = blockIdx.x * 4 + (threadIdx.x >> 6), lane = threadIdx.x & 63;
    const f32x4* xr = (const f32x4*)(x + (size_t)row * D) + lane;
    f32x4 v[4]; float s = 0.f;
#pragma unroll
    for (int j = 0; j < 4; ++j) { v[j] = xr[64 * j]; s += v[j].x * v[j].x + v[j].y * v[j].y + v[j].z * v[j].z + v[j].w * v[j].w; }
    const float rstd = 1.0f / sqrtf(wave_sum(s) * (1.0f / D) + RMS_EPS);
#pragma unroll
    for (int j = 0; j < 4; ++j) {
        const f32x4 gv = ((const f32x4*)g)[lane + 64 * j];
        unsigned long long w = (unsigned long long)(f2bf(v[j].x * rstd * gv.x) | (f2bf(v[j].y * rstd * gv.y) << 16)) |
                               ((unsigned long long)(f2bf(v[j].z * rstd * gv.z) | (f2bf(v[j].w * rstd * gv.w) << 16)) << 32);
        ((unsigned long long*)(out + (size_t)row * D))[lane + 64 * j] = w;
    }
}
__global__ void __launch_bounds__(256) k_resid(const float* base, const float* __restrict__ f, const float* __restrict__ g1, float scale,
                                               float* out, const float* __restrict__ g2, bf16_t* __restrict__ xn) {
    const int row = blockIdx.x * 4 + (threadIdx.x >> 6), lane = threadIdx.x & 63;
    const f32x4* fr = (const f32x4*)(f + (size_t)row * D) + lane;
    const f32x4* br = (const f32x4*)(base + (size_t)row * D) + lane;
    f32x4 v[4]; float s = 0.f;
#pragma unroll
    for (int j = 0; j < 4; ++j) { v[j] = fr[64 * j]; s += v[j].x * v[j].x + v[j].y * v[j].y + v[j].z * v[j].z + v[j].w * v[j].w; }
    const float rstd = scale / sqrtf(wave_sum(s) * (1.0f / D) + RMS_EPS);
    float s2 = 0.f;
#pragma unroll
    for (int j = 0; j < 4; ++j) {
        const f32x4 gv = ((const f32x4*)g1)[lane + 64 * j]; const f32x4 b = br[64 * j];
        v[j].x = b.x + v[j].x * rstd * gv.x; v[j].y = b.y + v[j].y * rstd * gv.y; v[j].z = b.z + v[j].z * rstd * gv.z; v[j].w = b.w + v[j].w * rstd * gv.w;
        ((f32x4*)(out + (size_t)row * D))[lane + 64 * j] = v[j];
        s2 += v[j].x * v[j].x + v[j].y * v[j].y + v[j].z * v[j].z + v[j].w * v[j].w;
    }
    if (xn) {
        const float r2 = 1.0f / sqrtf(wave_sum(s2) * (1.0f / D) + RMS_EPS);
#pragma unroll
        for (int j = 0; j < 4; ++j) {
            const f32x4 gv = ((const f32x4*)g2)[lane + 64 * j];
            unsigned long long w = (unsigned long long)(f2bf(v[j].x * r2 * gv.x) | (f2bf(v[j].y * r2 * gv.y) << 16)) |
                                   ((unsigned long long)(f2bf(v[j].z * r2 * gv.z) | (f2bf(v[j].w * r2 * gv.w) << 16)) << 32);
            ((unsigned long long*)(xn + (size_t)row * D))[lane + 64 * j] = w;
        }
    }
}

struct EpiP { bf16_t* o16; float* o32; int ldo; const float* bias; const bf16_t* aux; int ldaux; };
enum { E_SWIGLU = 0, E_F32 = 1, E_WIN = 2, E_GATE = 3, E_YA = 4, E_MERGE = 5 };
template <int EPI> __device__ __forceinline__ void epi_apply(const EpiP& p, int row, int col, float a, float b) {
    if (EPI == E_SWIGLU) { p.o16[(size_t)row * p.ldo + col] = (bf16_t)f2bf(a * sigmoidf_(a) * b); }
    else if (EPI == E_F32) { p.o32[(size_t)row * p.ldo + col] = a; }
    else if (EPI == E_WIN) { p.o16[(size_t)row * p.ldo + col] = (bf16_t)f2bf(col >= 2560 ? gelu_tanh(a) : a); }
    else if (EPI == E_GATE) { p.o16[(size_t)row * p.ldo + col] = (bf16_t)f2bf(sigmoidf_(a + p.bias[col])); }
    else if (EPI == E_YA) { p.o16[(size_t)row * p.ldo + col] = (bf16_t)f2bf(a * bf2f(p.aux[(size_t)row * p.ldaux + col])); }
    else if (EPI == E_MERGE) { const float t = bf2f(p.o16[(size_t)row * p.ldo + col]); p.o16[(size_t)row * p.ldo + col] = (bf16_t)f2bf(t + a * bf2f(p.aux[(size_t)row * p.ldaux + col])); }
}
template <int EPI, bool DUAL> __global__ void __launch_bounds__(256) k_gemm(const bf16_t* __restrict__ A, int lda, const float* __restrict__ B1, const float* __restrict__ B2, int ldb, int K, EpiP p) {
    __shared__ __attribute__((aligned(16))) bf16_t As[128][40];
    __shared__ __attribute__((aligned(16))) bf16_t Bs[DUAL ? 2 : 1][128][40];
    const int tid = threadIdx.x, wid = tid >> 6, lane = tid & 63, wr = wid >> 1, wc = wid & 1;
    const int m0 = blockIdx.y * 128, n0 = blockIdx.x * 128;
    f32x4 acc[DUAL ? 2 : 1][4][4];
#pragma unroll
    for (int d = 0; d < (DUAL ? 2 : 1); ++d)
#pragma unroll
        for (int m = 0; m < 4; ++m)
#pragma unroll
            for (int n = 0; n < 4; ++n) acc[d][m][n] = (f32x4){0.f, 0.f, 0.f, 0.f};
    for (int k0 = 0; k0 < K; k0 += 32) {
        __syncthreads();
#pragma unroll
        for (int i = 0; i < 2; ++i) { const int r = (tid >> 2) + 64 * i, c = tid & 3;
            *(bf16x8*)&As[r][c * 8] = *(const bf16x8*)(A + (size_t)(m0 + r) * lda + k0 + c * 8); }
        { const int n = tid & 127, kb = tid >> 7;
#pragma unroll
            for (int kk = 0; kk < 16; ++kk) { const int k = kb + 2 * kk;
                Bs[0][n][k] = (bf16_t)f2bf(B1[(size_t)(k0 + k) * ldb + n0 + n]);
                if (DUAL) Bs[DUAL ? 1 : 0][n][k] = (bf16_t)f2bf(B2[(size_t)(k0 + k) * ldb + n0 + n]); } }
        __syncthreads();
        bf16x8 a[4];
#pragma unroll
        for (int m = 0; m < 4; ++m) a[m] = *(const bf16x8*)&As[wr * 64 + m * 16 + (lane & 15)][8 * (lane >> 4)];
#pragma unroll
        for (int d = 0; d < (DUAL ? 2 : 1); ++d)
#pragma unroll
            for (int n = 0; n < 4; ++n) { const bf16x8 b = *(const bf16x8*)&Bs[d][wc * 64 + n * 16 + (lane & 15)][8 * (lane >> 4)];
#pragma unroll
                for (int m = 0; m < 4; ++m) acc[d][m][n] = __builtin_amdgcn_mfma_f32_16x16x32_bf16(a[m], b, acc[d][m][n], 0, 0, 0); }
    }
#pragma unroll
    for (int m = 0; m < 4; ++m)
#pragma unroll
        for (int n = 0; n < 4; ++n)
#pragma unroll
            for (int r = 0; r < 4; ++r) {
                const int row = m0 + wr * 64 + m * 16 + (lane >> 4) * 4 + r, col = n0 + wc * 64 + n * 16 + (lane & 15);
                epi_apply<EPI>(p, row, col, acc[0][m][n][r], DUAL ? acc[DUAL ? 1 : 0][m][n][r] : 0.f);
            }
}

__global__ void __launch_bounds__(64) k_lru(const bf16_t* __restrict__ proj, const float* __restrict__ conv_w, const float* __restrict__ conv_b,
                                            const float* __restrict__ wa, const float* __restrict__ ba, const float* __restrict__ wx, const float* __restrict__ bx,
                                            const float* __restrict__ lam, bf16_t* __restrict__ y) {
    __shared__ float sh[64];
    const int b = blockIdx.x >> 4, h = blockIdx.x & 15, c = threadIdx.x, ch = h * 64 + c;
    float war[64], wxr[64];
#pragma unroll
    for (int i = 0; i < 64; ++i) { war[i] = wa[(size_t)(h * 64 + i) * 64 + c]; wxr[i] = wx[(size_t)(h * 64 + i) * 64 + c]; }
    const float c0 = conv_w[ch], c1 = conv_w[1024 + ch], c2 = conv_w[2048 + ch], c3 = conv_w[3072 + ch], cb = conv_b[ch];
    const float bav = ba[ch], bxv = bx[ch];
    const float la = -log1pf(__expf(-lam[ch]));
    float x3 = 0.f, x2 = 0.f, x1 = 0.f, hs = 0.f;
    for (int t = 0; t < SEQ; ++t) {
        const size_t row = (size_t)b * SEQ + t;
        const float x0 = bf2f(proj[row * INW + 1536 + ch]);
        const float xc = cb + c0 * x3 + c1 * x2 + c2 * x1 + c3 * x0;
        x3 = x2; x2 = x1; x1 = x0;
        __syncthreads();
        sh[c] = xc;
        __syncthreads();
        float ra = bav, ri = bxv;
#pragma unroll
        for (int i = 0; i < 64; ++i) { const float xv = sh[i]; ra += xv * war[i]; ri += xv * wxr[i]; }
        const float r = sigmoidf_(ra), ig = sigmoidf_(ri);
        const float log_a = 8.0f * r * la;
        const float a = __expf(log_a);
        const float u = sqrtf(fmaxf(1.0f - a * a, 0.f)) * (ig * xc);
        hs = a * hs + u;
        const float g = bf2f(proj[row * INW + 2560 + ch]);
        y[row * D + ch] = (bf16_t)f2bf(hs * g);
    }
}

__device__ __forceinline__ int t5_bucket(int rel) {
    const int ret = rel > 0 ? 16 : 0; const int n = rel < 0 ? -rel : rel;
    if (n < 8) return ret + n;
    const int lg = n < 12 ? 8 : n < 16 ? 9 : n < 23 ? 10 : n < 32 ? 11 : n < 46 ? 12 : n < 64 ? 13 : n < 91 ? 14 : 15;
    return ret + lg;
}
__global__ void __launch_bounds__(64) k_attn(const bf16_t* __restrict__ proj, const float* __restrict__ sinks, const float* __restrict__ rel_bias, bf16_t* __restrict__ o) {
    __shared__ bf16_t ks[192][64];
    __shared__ bf16_t vs[192][64];
    __shared__ float tb[256];
    const int h = blockIdx.x & 15, n = (blockIdx.x >> 4) & 63, b = blockIdx.x >> 10, i = threadIdx.x, g = h >> 2;
    const size_t row = (size_t)b * SEQ + n * 64 + i;
    for (int e = i; e < 255; e += 64) tb[e] = rel_bias[t5_bucket(e - 191) * 16 + h];
    for (int j = 0; j < 192; ++j) {
        const int tok = (n - 2) * 64 + j;
        if (tok >= 0) { const size_t kr = (size_t)b * SEQ + tok;
            ks[j][i] = proj[kr * INW + 1024 + g * 64 + i]; vs[j][i] = proj[kr * INW + 1280 + g * 64 + i]; }
    }
    float q[64], acc[64];
#pragma unroll
    for (int d = 0; d < 64; ++d) { q[d] = bf2f(proj[row * INW + h * 64 + d]); acc[d] = 0.f; }
    __syncthreads();
    float mx = -1e30f, l = 0.f;
    for (int j = 0; j < 192; ++j) {
        const int tok = (n - 2) * 64 + j;
        if (tok < 0) continue;
        float s = 0.f;
#pragma unroll
        for (int d = 0; d < 64; ++d) s += q[d] * bf2f(ks[j][d]);
        s = s * 0.125f + tb[j - 128 - i + 191];
        const float mn = fmaxf(mx, s), corr = __expf(mx - mn), pe = __expf(s - mn);
        l = l * corr + pe;
#pragma unroll
        for (int d = 0; d < 64; ++d) acc[d] = acc[d] * corr + pe * bf2f(vs[j][d]);
        mx = mn;
    }
    { const float sk = sinks[h]; const float mn = fmaxf(mx, sk), corr = __expf(mx - mn);
      l = l * corr + __expf(sk - mn);
#pragma unroll
      for (int d = 0; d < 64; ++d) acc[d] *= corr; }
    const float inv = 1.0f / l;
#pragma unroll
    for (int d = 0; d < 64; ++d) o[row * D + h * 64 + d] = (bf16_t)f2bf(acc[d] * inv);
}

extern "C" void kernel_launch(void* const* d_in, const int* in_sizes, int n_in, void* d_out, int out_size, void* d_ws, size_t ws_size, hipStream_t stream) {
    const float* x = (const float*)d_in[0];
    const float* f1_pre = (const float*)d_in[1]; const float* f1_w1 = (const float*)d_in[2]; const float* f1_w3 = (const float*)d_in[3];
    const float* f1_w2 = (const float*)d_in[4]; const float* f1_post = (const float*)d_in[5]; const float* mix_pre = (const float*)d_in[6];
    const float* w_in = (const float*)d_in[7]; const float* conv_w = (const float*)d_in[8]; const float* conv_b = (const float*)d_in[9];
    const float* rg_a_w = (const float*)d_in[10]; const float* rg_a_b = (const float*)d_in[11]; const float* rg_x_w = (const float*)d_in[12];
    const float* rg_x_b = (const float*)d_in[13]; const float* lam = (const float*)d_in[14]; const float* w_lru_out = (const float*)d_in[15];
    const float* sinks = (const float*)d_in[16]; const float* rel_bias = (const float*)d_in[17]; const float* w_attn_out = (const float*)d_in[18];
    const float* w_gate = (const float*)d_in[19]; const float* b_gate = (const float*)d_in[20]; const float* w_o = (const float*)d_in[21];
    const float* mix_post = (const float*)d_in[22]; const float* f2_pre = (const float*)d_in[23]; const float* f2_w1 = (const float*)d_in[24];
    const float* f2_w3 = (const float*)d_in[25]; const float* f2_w2 = (const float*)d_in[26]; const float* f2_post = (const float*)d_in[27];
    float* out = (float*)d_out;
    unsigned char* ws = (unsigned char*)d_ws;
    const size_t MiB = 1u << 20;
    bf16_t* XN = (bf16_t*)(ws + 2 * MiB);
    bf16_t* ACT = (bf16_t*)(ws + 34 * MiB);
    bf16_t* PROJ = (bf16_t*)(ws + 34 * MiB);
    float* F = (float*)(ws + 146 * MiB);
    bf16_t* GATES = (bf16_t*)(ws + 146 * MiB);
    bf16_t* LRUY = (bf16_t*)(ws + 210 * MiB);
    bf16_t* ATT = XN;
    bf16_t* T = (bf16_t*)(ws + 34 * MiB);
    float* F2 = (float*)(ws + 98 * MiB);
    const dim3 blk(256);
    k_rmsnorm<<<M / 4, blk, 0, stream>>>(x, f1_pre, XN);
    { EpiP p{ACT, nullptr, DFF, nullptr, nullptr, 0}; k_gemm<E_SWIGLU, true><<<dim3(DFF / 128, M / 128), blk, 0, stream>>>(XN, D, f1_w1, f1_w3, DFF, D, p); }
    { EpiP p{nullptr, F, D, nullptr, nullptr, 0}; k_gemm<E_F32, false><<<dim3(D / 128, M / 128), blk, 0, stream>>>(ACT, DFF, f1_w2, nullptr, D, DFF, p); }
    k_resid<<<M / 4, blk, 0, stream>>>(x, F, f1_post, 0.5f, out, mix_pre, XN);
    { EpiP p{PROJ, nullptr, INW, nullptr, nullptr, 0}; k_gemm<E_WIN, false><<<dim3(INW / 128, M / 128), blk, 0, stream>>>(XN, D, w_in, nullptr, INW, D, p); }
    { EpiP p{GATES, nullptr, 2 * D, b_gate, nullptr, 0}; k_gemm<E_GATE, false><<<dim3(2 * D / 128, M / 128), blk, 0, stream>>>(XN, D, w_gate, nullptr, 2 * D, D, p); }
    k_lru<<<BATCH * 16, 64, 0, stream>>>(PROJ, conv_w, conv_b, rg_a_w, rg_a_b, rg_x_w, rg_x_b, lam, LRUY);
    k_attn<<<BATCH * 64 * 16, 64, 0, stream>>>(PROJ, sinks, rel_bias, ATT);
    { EpiP p{T, nullptr, D, nullptr, GATES, 2 * D}; k_gemm<E_YA, false><<<dim3(D / 128, M / 128), blk, 0, stream>>>(LRUY, D, w_lru_out, nullptr, D, D, p); }
    { EpiP p{T, nullptr, D, nullptr, GATES + D, 2 * D}; k_gemm<E_MERGE, false><<<dim3(D / 128, M / 128), blk, 0, stream>>>(ATT, D, w_attn_out, nullptr, D, D, p); }
    { EpiP p{nullptr, F2, D, nullptr, nullptr, 0}; k_gemm<E_F32, false><<<dim3(D / 128, M / 128), blk, 0, stream>>>(T, D, w_o, nullptr, D, D, p); }
    k_resid<<<M / 4, blk, 0, stream>>>(out, F2, mix_post, 1.0f, out, f2_pre, XN);
    bf16_t* ACT2 = (bf16_t*)(ws + 34 * MiB); float* F3 = (float*)(ws + 146 * MiB);
    { EpiP p{ACT2, nullptr, DFF, nullptr, nullptr, 0}; k_gemm<E_SWIGLU, true><<<dim3(DFF / 128, M / 128), blk, 0, stream>>>(XN, D, f2_w1, f2_w3, DFF, D, p); }
    { EpiP p{nullptr, F3, D, nullptr, nullptr, 0}; k_gemm<E_F32, false><<<dim3(D / 128, M / 128), blk, 0, stream>>>(ACT2, DFF, f2_w2, nullptr, D, DFF, p); }
    k_resid<<<M / 4, blk, 0, stream>>>(out, F3, f2_post, 0.5f, out, nullptr, nullptr);
}
```
